# Optimizing an MI355X kernel written in HIP

```python
import math
import jax, jax.numpy as jnp
from jax import lax
import numpy as np


D_MODEL = 1024
BATCH = 32
SEQ = 2048
DEPTH = 1

CHUNK = 64
RET_HEADS = 4
RET_HEAD_DIM = 128
RET_WIDTH = RET_HEADS * RET_HEAD_DIM
ROPE_BASE = 10000.0
SG_BLOCK = 128
SG_GROUPS = 4
SG_DIM = 128
SG_WIDTH = SG_GROUPS * SG_DIM
MIX_WIDTH = RET_WIDTH + SG_WIDTH
IN_SPLITS = (RET_WIDTH, RET_WIDTH, RET_WIDTH, RET_WIDTH, SG_WIDTH, SG_WIDTH)
IN_WIDTH = sum(IN_SPLITS)
D_FF = 4 * D_MODEL
PLE_DIM = 256
EPS = 1e-6

kernel_name = "hybrid_retention_gmlp_streaming_layer"


def rmsnorm(x, g):
    xf = x.astype(jnp.float32)
    y = xf * lax.rsqrt(jnp.mean(xf * xf, axis=-1, keepdims=True) + EPS)
    return (y * g.astype(jnp.float32)).astype(x.dtype)


def layernorm_nogain(xf):
    mu = jnp.mean(xf, axis=-1, keepdims=True)
    xc = xf - mu
    return xc * lax.rsqrt(jnp.mean(xc * xc, axis=-1, keepdims=True) + EPS)


def rotary(x, pos):
    d = x.shape[-1]
    freqs = ROPE_BASE ** (-jnp.arange(0, d, 2, dtype=jnp.float32) / d)
    ang = pos[:, None] * freqs[None, :]
    cos = jnp.cos(ang)[None, :, None, :].astype(x.dtype)
    sin = jnp.sin(ang)[None, :, None, :].astype(x.dtype)
    x1, x2 = x[..., : d // 2], x[..., d // 2:]
    return jnp.concatenate([x1 * cos - x2 * sin, x2 * cos + x1 * sin], axis=-1)


def chunk_retention(q, k, v):
    B, S, H, D = q.shape
    N = S // CHUNK
    q, k, v = (a.astype(jnp.float32) for a in (q, k, v))
    log_g = jnp.log(1.0 - 2.0 ** (-5.0 - jnp.arange(H, dtype=jnp.float32)))
    t = jnp.arange(CHUNK, dtype=jnp.float32)
    intra_decay = jnp.exp(jnp.abs(t[:, None] - t[None, :])[None] * log_g[:, None, None])
    q_dec = jnp.exp((t[:, None] + 1.0) * log_g[None, :])
    k_dec = jnp.exp((CHUNK - 1.0 - t)[:, None] * log_g[None, :])
    c_dec = jnp.exp(CHUNK * log_g)

    qc = q.reshape(B, N, CHUNK, H, D)
    kc = k.reshape(B, N, CHUNK, H, D)
    vc = v.reshape(B, N, CHUNK, H, D)
    scores = jnp.einsum('bnihd,bnjhd->bnhij', qc, kc) * intra_decay
    o_intra = jnp.einsum('bnhij,bnjhe->bnihe', scores, vc)

    def step(state, inp):
        qn, kn, vn = inp
        o = jnp.einsum('bihd,bhde->bihe', qn * q_dec[None, :, :, None], state)
        state = state * c_dec[None, :, None, None] + jnp.einsum(
            'bjhd,bjhe->bhde', kn * k_dec[None, :, :, None], vn)
        return state, o

    xs = (qc.transpose(1, 0, 2, 3, 4), kc.transpose(1, 0, 2, 3, 4), vc.transpose(1, 0, 2, 3, 4))
    state0 = jnp.zeros((B, H, D, D), jnp.float32)
    _, o_cross = lax.scan(step, state0, xs)
    o = o_intra + o_cross.transpose(1, 0, 2, 3, 4)
    return o.reshape(B, S, H, D)


def spatial_gating(u, sv, w_s, b_s, sg_g):
    B, S, _ = sv.shape
    svn = (layernorm_nogain(sv.astype(jnp.float32)) * sg_g.astype(jnp.float32)).astype(sv.dtype)
    vb = svn.reshape(B, S // SG_BLOCK, SG_BLOCK, SG_GROUPS, SG_DIM)
    idx = jnp.arange(SG_BLOCK)
    allowed = (idx[None, :] // CHUNK) <= (idx[:, None] // CHUNK)
    w = jnp.where(allowed[None], w_s, jnp.zeros_like(w_s)).astype(sv.dtype)
    s = jnp.einsum('gij,bnjgc->bnigc', w, vb) + b_s.T.astype(sv.dtype)[None, None, :, :, None]
    return u * s.reshape(B, S, SG_WIDTH)


def setup_inputs(seed: int = 0) -> dict:
    key = jax.random.key(seed)
    ks = jax.random.split(key, 20)
    f32 = jnp.float32
    nrm = lambda k, shape, scale: jax.random.normal(k, shape, f32) * scale
    gain = lambda k, shape: 1.0 + 0.01 * jax.random.normal(k, shape, f32)
    return {
        "x": jax.random.normal(ks[0], (BATCH, SEQ, D_MODEL), f32),
        "p": jax.random.normal(ks[1], (DEPTH, BATCH, SEQ, PLE_DIM), f32),
        "g_mix": gain(ks[2], (DEPTH, D_MODEL)),
        "w_in": nrm(ks[3], (DEPTH, D_MODEL, IN_WIDTH), D_MODEL ** -0.5),
        "ret_norm_g": gain(ks[4], (DEPTH, RET_WIDTH)),
        "sg_norm_g": gain(ks[5], (DEPTH, SG_WIDTH)),
        "w_s": nrm(ks[6], (DEPTH, SG_GROUPS, SG_BLOCK, SG_BLOCK), SG_BLOCK ** -0.5),
        "b_s": gain(ks[7], (DEPTH, SG_GROUPS, SG_BLOCK)),
        "w_out": nrm(ks[8], (DEPTH, MIX_WIDTH, D_MODEL), MIX_WIDTH ** -0.5),
        "g_ffn": gain(ks[9], (DEPTH, D_MODEL)),
        "w_ff1": nrm(ks[10], (DEPTH, D_MODEL, D_FF), D_MODEL ** -0.5),
        "w_ff2": nrm(ks[11], (DEPTH, D_FF, D_MODEL), D_FF ** -0.5),
        "g_ple": gain(ks[12], (DEPTH, D_MODEL)),
        "w_ple_gate": nrm(ks[13], (DEPTH, D_MODEL, D_MODEL), D_MODEL ** -0.5),
        "w_ple": nrm(ks[14], (DEPTH, PLE_DIM, D_MODEL), PLE_DIM ** -0.5),
        "g_final": gain(ks[15], (D_MODEL,)),
    }


def reference(x, p, g_mix, w_in, ret_norm_g, sg_norm_g, w_s, b_s, w_out, g_ffn,
              w_ff1, w_ff2, g_ple, w_ple_gate, w_ple, g_final):
    B, S, _ = x.shape
    pos = jnp.arange(S, dtype=jnp.float32)
    cuts = list(np.cumsum(IN_SPLITS)[:-1])
    for i in range(DEPTH):
        h = rmsnorm(x, g_mix[i])
        z = h @ w_in[i]
        q, k, v, g, u, sv = jnp.split(z, cuts, axis=-1)
        q = rotary(q.reshape(B, S, RET_HEADS, RET_HEAD_DIM), pos)
        k = rotary(k.reshape(B, S, RET_HEADS, RET_HEAD_DIM), pos) * (RET_HEAD_DIM ** -0.5)
        v = v.reshape(B, S, RET_HEADS, RET_HEAD_DIM)
        r = chunk_retention(q, k, v)
        r = layernorm_nogain(r).reshape(B, S, RET_WIDTH) * ret_norm_g[i].astype(jnp.float32)
        y_ret = jax.nn.silu(g) * r.astype(x.dtype)
        y_sg = spatial_gating(jax.nn.gelu(u), jax.nn.gelu(sv), w_s[i], b_s[i], sg_norm_g[i])
        x = x + jnp.concatenate([y_ret, y_sg], axis=-1) @ w_out[i]
        hf = rmsnorm(x, g_ffn[i]) @ w_ff1[i]
        x = x + jnp.square(jax.nn.relu(hf)) @ w_ff2[i]
        gate = jax.nn.sigmoid(rmsnorm(x, g_ple[i]) @ w_ple_gate[i])
        x = x + gate * (p[i] @ w_ple[i])
    return rmsnorm(x, g_final)
```

```cpp
#include <hip/hip_runtime.h>
#include <hip/hip_cooperative_groups.h>
#include <cstdio>
#include <cstdint>
namespace cg = cooperative_groups;

#ifndef MK_N_LAUNCHES
#define MK_N_LAUNCHES 1
#endif

#define LAS __attribute__((address_space(3)))
#define DI __device__ __forceinline__
typedef unsigned short bf16_t;
typedef short bf16x8 __attribute__((ext_vector_type(8)));
typedef short s16x4 __attribute__((ext_vector_type(4)));
typedef float f32x4 __attribute__((ext_vector_type(4)));
typedef float f32x2 __attribute__((ext_vector_type(2)));
typedef unsigned u32x4 __attribute__((ext_vector_type(4)));
typedef unsigned u32x2 __attribute__((ext_vector_type(2)));

constexpr int MTOK = 65536, SEQ = 2048, DM = 1024, NIN = 3072, DFF = 4096, PLE = 256;
constexpr float EPS = 1e-6f;
constexpr size_t MiB = 1u << 20;
constexpr size_t WS_WIN = 1 * MiB, WS_WOUT = 7 * MiB, WS_WFF1 = 9 * MiB, WS_WFF2 = 17 * MiB, WS_WGATE = 25 * MiB, WS_WPLE = 27 * MiB;
constexpr size_t WS_WS = 27 * MiB + 512 * 1024, WS_ROPE = 28 * MiB, WS_SS1 = 29 * MiB, WS_SS2 = 33 * MiB, WS_SS3 = 37 * MiB;
constexpr size_t WS_H0 = 48 * MiB;
constexpr size_t WS_A1 = 176 * MiB;
constexpr size_t WS_Z = 304 * MiB;
constexpr size_t WS_PB = 816 * MiB;
constexpr size_t WS_PW = 848 * MiB;
constexpr size_t WS_END = 976 * MiB;
constexpr int LDS_BYTES = 147456;

DI unsigned cvt_pk_bf16(float lo, float hi) { unsigned r; asm volatile("v_cvt_pk_bf16_f32 %0, %1, %2" : "=v"(r) : "v"(lo), "v"(hi)); return r; }
DI float bf_lo(unsigned w) { return __uint_as_float(w << 16); }
DI float bf_hi(unsigned w) { return __uint_as_float(w & 0xffff0000u); }
DI float fast_sigmoid(float x) { return __builtin_amdgcn_rcpf(1.0f + __builtin_amdgcn_exp2f(-1.4426950409f * x)); }
DI float silu_f(float x) { return x * fast_sigmoid(x); }
DI float gelu_tanh_f(float x) { return x * fast_sigmoid(1.5957691216f * (x + 0.044715f * x * x * x)); }
DI float wave_sum(float v) {
#pragma unroll
    for (int o = 1; o < 64; o <<= 1) v += __shfl_xor(v, o);
    return v;
}

namespace pg8 {
#define PG8_LAS __attribute__((address_space(3)))
constexpr int BM = 256, BK = 64, HALF = 128, HTB = HALF * BK * 2, STAGE_BYTES = 8 * HTB, NXCD = 8, WGM = 8;
__host__ __device__ __forceinline__ int lds_byte(int r, int c) { const int st = (r >> 4) * 2 + (c >> 5), rr = r & 15, cc = c & 31, ob = rr * 64 + cc * 2; return st * 1024 + (ob ^ (((ob >> 9) & 1) << 5)); }
__host__ __device__ __forceinline__ void stage_rc(int b, int& R, int& C) { const int st = b / 1024, sb = b % 1024, swz = sb ^ (((sb >> 9) & 1) << 5); R = (st >> 1) * 16 + swz / 64; C = (st & 1) * 32 + (swz % 64) / 2; }
__host__ __device__ __forceinline__ int perm32(int rho) { const int n = rho >> 4, i = rho & 15; return 8 * (i >> 2) + 4 * n + (i & 3); }
struct Unit { int pm, pn; };
struct Gemm { const bf16_t* A; const bf16_t* Bt; int M, N, K; };
struct StaticOrder {
    int nM, nN, nwg, G, c;
    __host__ __device__ void init(int M, int N, int G_, int c_) { nM = M / BM; nN = N / BM; nwg = nM * nN; G = G_; c = c_; }
    __host__ __device__ bool next(int i, Unit& u) const {
        const long L = (long)i * G + c; if (L >= nwg) return false;
        int wgid = (int)L; { const int q = nwg / NXCD, r = nwg % NXCD, xcd = wgid % NXCD, off = wgid / NXCD; wgid = (xcd < r ? xcd * (q + 1) : r * (q + 1) + (xcd - r) * q) + off; }
        const int nig = WGM * nN, gid = wgid / nig, fm = gid * WGM, gsz = (nM - fm) < WGM ? (nM - fm) : WGM;
        u.pm = fm + ((wgid % nig) % gsz); u.pn = (wgid % nig) / gsz; return true;
    }
    __device__ __forceinline__ void a_ready(const Unit&) const {}
    __device__ __forceinline__ void done(const Unit&) const {}
};

enum { EPI_IN = 0, EPI_RES = 1, EPI_FF1 = 2, EPI_GATE = 3, EPI_PLAIN = 4 };
template <int MODE> struct Epi {
    static constexpr bool PERM = true, AFTER_DRAIN = false;
    bf16_t* O; int ldc;
    const float* resid;
    float* xout;
    const float* gain;
    const float* ss_in;
    float* ss_out;
    const bf16_t* pw;
    const float* rope;
    __device__ __forceinline__ void operator()(const f32x4 (&acc)[2][2][4][2], const Unit& u, int wr, int wc, int fr, int fq) const {
        const int row0 = u.pm * BM + wr * 64 + fr, col0 = u.pn * BM + wc * 32 + 8 * fq;
        if constexpr (MODE == EPI_PLAIN) {
#pragma unroll
            for (int ai = 0; ai < 2; ++ai)
#pragma unroll
                for (int m = 0; m < 4; ++m) { bf16_t* rowp = O + (size_t)(row0 + ai * HALF + m * 16) * ldc + col0;
#pragma unroll
                    for (int bj = 0; bj < 2; ++bj) { const f32x4 v0 = acc[ai][bj][m][0], v1 = acc[ai][bj][m][1]; u32x4 w; w.x = cvt_pk_bf16(v0[0], v0[1]); w.y = cvt_pk_bf16(v0[2], v0[3]); w.z = cvt_pk_bf16(v1[0], v1[1]); w.w = cvt_pk_bf16(v1[2], v1[3]);
                        *(u32x4*)(rowp + bj * HALF) = w; } }
        } else if constexpr (MODE == EPI_IN) {
            const int kind = u.pn >> 1;
            const float sc = (kind == 1) ? 0.08838834764831845f : 1.0f;
#pragma unroll
            for (int ai = 0; ai < 2; ++ai)
#pragma unroll
                for (int m = 0; m < 4; ++m) { const int row = row0 + ai * HALF + m * 16; bf16_t* rowp = O + (size_t)row * ldc + col0;
                    f32x4 cs = (f32x4){1.f, 1.f, 1.f, 1.f}, sn = (f32x4){0.f, 0.f, 0.f, 0.f};
                    if (kind < 2) { const float* rp = rope + (size_t)(row & (SEQ - 1)) * 64 + 16 * wc + 4 * fq; cs = *(const f32x4*)rp; sn = *(const f32x4*)(rp + SEQ * 64); }
#pragma unroll
                    for (int bj = 0; bj < 2; ++bj) { f32x4 v0 = acc[ai][bj][m][0], v1 = acc[ai][bj][m][1];
                        if (kind < 2) {
                            const f32x4 a0 = v0, a1 = v1;
                            v0[0] = (a0[0] * cs[0] - a0[1] * sn[0]) * sc; v0[1] = (a0[1] * cs[0] + a0[0] * sn[0]) * sc;
                            v0[2] = (a0[2] * cs[1] - a0[3] * sn[1]) * sc; v0[3] = (a0[3] * cs[1] + a0[2] * sn[1]) * sc;
                            v1[0] = (a1[0] * cs[2] - a1[1] * sn[2]) * sc; v1[1] = (a1[1] * cs[2] + a1[0] * sn[2]) * sc;
                            v1[2] = (a1[2] * cs[3] - a1[3] * sn[3]) * sc; v1[3] = (a1[3] * cs[3] + a1[2] * sn[3]) * sc;
                        } else if (kind == 3) {
#pragma unroll
                            for (int e = 0; e < 4; ++e) { v0[e] = silu_f(v0[e]); v1[e] = silu_f(v1[e]); }
                        } else if (kind >= 4) {
#pragma unroll
                            for (int e = 0; e < 4; ++e) { v0[e] = gelu_tanh_f(v0[e]); v1[e] = gelu_tanh_f(v1[e]); }
                        }
                        u32x4 w; w.x = cvt_pk_bf16(v0[0], v0[1]); w.y = cvt_pk_bf16(v0[2], v0[3]); w.z = cvt_pk_bf16(v1[0], v1[1]); w.w = cvt_pk_bf16(v1[2], v1[3]);
                        *(u32x4*)(rowp + bj * HALF) = w; } }
        } else if constexpr (MODE == EPI_RES) {
            f32x4 gv[2][2];
#pragma unroll
            for (int bj = 0; bj < 2; ++bj)
#pragma unroll
                for (int n = 0; n < 2; ++n) gv[bj][n] = *(const f32x4*)(gain + col0 + bj * HALF + 4 * n);
#pragma unroll
            for (int ai = 0; ai < 2; ++ai)
#pragma unroll
                for (int m = 0; m < 4; ++m) { const int row = row0 + ai * HALF + m * 16; const size_t off = (size_t)row * DM + col0; float ss = 0.f;
#pragma unroll
                    for (int bj = 0; bj < 2; ++bj) {
                        const f32x4 xa = *(const f32x4*)(resid + off + bj * HALF), xb = *(const f32x4*)(resid + off + bj * HALF + 4);
                        const f32x4 v0 = acc[ai][bj][m][0] + xa, v1 = acc[ai][bj][m][1] + xb;
                        *(f32x4*)(xout + off + bj * HALF) = v0; *(f32x4*)(xout + off + bj * HALF + 4) = v1;
                        ss += (v0[0] * v0[0] + v0[1] * v0[1]) + (v0[2] * v0[2] + v0[3] * v0[3]) + (v1[0] * v1[0] + v1[1] * v1[1]) + (v1[2] * v1[2] + v1[3] * v1[3]);
                        const f32x4 b0 = v0 * gv[bj][0], b1 = v1 * gv[bj][1];
                        u32x4 w; w.x = cvt_pk_bf16(b0[0], b0[1]); w.y = cvt_pk_bf16(b0[2], b0[3]); w.z = cvt_pk_bf16(b1[0], b1[1]); w.w = cvt_pk_bf16(b1[2], b1[3]);
                        *(u32x4*)(O + off + bj * HALF) = w; }
                    ss += __shfl_xor(ss, 16); ss += __shfl_xor(ss, 32);
                    if (fq == 0) ss_out[(size_t)row * 16 + u.pn * 4 + wc] = ss; }
        } else if constexpr (MODE == EPI_FF1) {
#pragma unroll
            for (int ai = 0; ai < 2; ++ai)
#pragma unroll
                for (int m = 0; m < 4; ++m) { const int row = row0 + ai * HALF + m * 16; bf16_t* rowp = O + (size_t)row * ldc + col0;
                    const f32x4 pp = *(const f32x4*)(ss_in + (size_t)row * 16 + 4 * fq); float s = (pp[0] + pp[1]) + (pp[2] + pp[3]); s += __shfl_xor(s, 16); s += __shfl_xor(s, 32);
                    const float rstd = __builtin_amdgcn_rsqf(s * (1.0f / DM) + EPS);
#pragma unroll
                    for (int bj = 0; bj < 2; ++bj) { f32x4 v0 = acc[ai][bj][m][0] * rstd, v1 = acc[ai][bj][m][1] * rstd;
#pragma unroll
                        for (int e = 0; e < 4; ++e) { const float a = fmaxf(v0[e], 0.f), b = fmaxf(v1[e], 0.f); v0[e] = a * a; v1[e] = b * b; }
                        u32x4 w; w.x = cvt_pk_bf16(v0[0], v0[1]); w.y = cvt_pk_bf16(v0[2], v0[3]); w.z = cvt_pk_bf16(v1[0], v1[1]); w.w = cvt_pk_bf16(v1[2], v1[3]);
                        *(u32x4*)(rowp + bj * HALF) = w; } }
        } else if constexpr (MODE == EPI_GATE) {
#pragma unroll
            for (int ai = 0; ai < 2; ++ai)
#pragma unroll
                for (int m = 0; m < 4; ++m) { const int row = row0 + ai * HALF + m * 16; const size_t off = (size_t)row * DM + col0; float ss = 0.f;
                    const f32x4 pp = *(const f32x4*)(ss_in + (size_t)row * 16 + 4 * fq); float s = (pp[0] + pp[1]) + (pp[2] + pp[3]); s += __shfl_xor(s, 16); s += __shfl_xor(s, 32);
                    const float rstd = __builtin_amdgcn_rsqf(s * (1.0f / DM) + EPS);
#pragma unroll
                    for (int bj = 0; bj < 2; ++bj) {
                        const f32x4 xa = *(const f32x4*)(resid + off + bj * HALF), xb = *(const f32x4*)(resid + off + bj * HALF + 4);
                        const u32x4 pv = *(const u32x4*)(pw + off + bj * HALF);
                        f32x4 v0 = acc[ai][bj][m][0] * rstd, v1 = acc[ai][bj][m][1] * rstd;
                        v0[0] = xa[0] + fast_sigmoid(v0[0]) * bf_lo(pv.x); v0[1] = xa[1] + fast_sigmoid(v0[1]) * bf_hi(pv.x);
                        v0[2] = xa[2] + fast_sigmoid(v0[2]) * bf_lo(pv.y); v0[3] = xa[3] + fast_sigmoid(v0[3]) * bf_hi(pv.y);
                        v1[0] = xb[0] + fast_sigmoid(v1[0]) * bf_lo(pv.z); v1[1] = xb[1] + fast_sigmoid(v1[1]) * bf_hi(pv.z);
                        v1[2] = xb[2] + fast_sigmoid(v1[2]) * bf_lo(pv.w); v1[3] = xb[3] + fast_sigmoid(v1[3]) * bf_hi(pv.w);
                        *(f32x4*)(xout + off + bj * HALF) = v0; *(f32x4*)(xout + off + bj * HALF + 4) = v1;
                        ss += (v0[0] * v0[0] + v0[1] * v0[1]) + (v0[2] * v0[2] + v0[3] * v0[3]) + (v1[0] * v1[0] + v1[1] * v1[1]) + (v1[2] * v1[2] + v1[3] * v1[3]); }
                    ss += __shfl_xor(ss, 16); ss += __shfl_xor(ss, 32);
                    if (fq == 0) ss_out[(size_t)row * 16 + u.pn * 4 + wc] = ss; }
        }
    }
};

template <class Epi, class Sched, bool ALIGN_EPI = false, bool SP2 = false>
__device__ __forceinline__ void gemm_phase(PG8_LAS unsigned char* lds, const Gemm g, const Sched& S, const Epi& E) {
    const int tid = threadIdx.x, wid = __builtin_amdgcn_readfirstlane(tid >> 6), lane = tid & 63, wr = wid >> 2, wc = wid & 3, fr = lane & 15, fq = lane >> 4;
    const int K = g.K, nt = K / BK;
    unsigned voffA[2], voffB[2];
#pragma unroll
    for (int i = 0; i < 2; ++i) { int R, C; stage_rc(tid * 16 + i * 8192, R, C); const int Rb = Epi::PERM ? ((R & ~31) + perm32(R & 31)) : R;
        voffA[i] = (unsigned)(R * K + C) * 2u; voffB[i] = (unsigned)(Rb * K + C) * 2u; }
    const size_t kstep = (size_t)(BK * 2);
    const size_t hstep = (size_t)HALF * K * 2;
    const size_t tstep = 2 * hstep;
    const unsigned ldsw = (unsigned)wid * 1024u;
    const int aoff = lds_byte(wr * 64 + fr, fq * 8), boff = lds_byte(wc * 32 + fr, fq * 8);
#define PG8_SA(b, h) (((b) * 2 + (h)) * HTB)
#define PG8_SB(b, h) ((4 + (b) * 2 + (h)) * HTB)
#define PG8_STAGE(bufoff, gbase, voff) do { _Pragma("unroll") for (int _i = 0; _i < 2; ++_i) \
        __builtin_amdgcn_global_load_lds((const unsigned*)((const char*)(gbase) + (voff)[_i]), (PG8_LAS unsigned*)(lds + (bufoff) + ldsw + _i * 8192), 16, 0, 0); } while (0)
#define PG8_LDA(dst, b, h) do { _Pragma("unroll") for (int m = 0; m < 4; ++m) _Pragma("unroll") for (int k = 0; k < 2; ++k) dst[m][k] = *(const PG8_LAS bf16x8*)(lds + PG8_SA(b, h) + aoff + m * 2048 + k * 1024); } while (0)
#define PG8_LDB(dst, b, h) do { _Pragma("unroll") for (int n = 0; n < 2; ++n) _Pragma("unroll") for (int k = 0; k < 2; ++k) dst[n][k] = *(const PG8_LAS bf16x8*)(lds + PG8_SB(b, h) + boff + n * 2048 + k * 1024); } while (0)
#define PG8_MMA(ai, bj, At, Bt) do { __builtin_amdgcn_s_setprio(1); _Pragma("unroll") for (int m = 0; m < 4; ++m) _Pragma("unroll") for (int n = 0; n < 2; ++n) _Pragma("unroll") for (int k = 0; k < 2; ++k) \
        acc[ai][bj][m][n] = __builtin_amdgcn_mfma_f32_16x16x32_bf16(Bt[n][k], At[m][k], acc[ai][bj][m][n], 0, 0, 0); __builtin_amdgcn_s_setprio(0); } while (0)
#define PG8_WAIT_V(n) asm volatile("s_waitcnt vmcnt(" #n ")" ::: "memory")
#define PG8_WAIT_L(n) asm volatile("s_waitcnt lgkmcnt(" #n ")" ::: "memory")
#define PG8_BAR __builtin_amdgcn_s_barrier()
#define PG8_SCHED __builtin_amdgcn_sched_barrier(0)
    Unit cur, nxt; int ui = 0;
    if (!S.next(0, cur)) return;
    f32x4 acc[2][2][4][2];
#pragma unroll
    for (int a = 0; a < 2; ++a)
#pragma unroll
        for (int b = 0; b < 2; ++b)
#pragma unroll
            for (int m = 0; m < 4; ++m)
#pragma unroll
                for (int n = 0; n < 2; ++n) acc[a][b][m][n] = (f32x4){0.f, 0.f, 0.f, 0.f};
    bf16x8 At[4][2], B0[2][2], B1[2][2];
    const char* cA = (const char*)g.A + (size_t)cur.pm * tstep; const char* cB = (const char*)g.Bt + (size_t)cur.pn * tstep;
    S.a_ready(cur);
    if constexpr (SP2) {
        PG8_STAGE(PG8_SB(0, 0), cB, voffB); PG8_STAGE(PG8_SB(0, 1), cB + hstep, voffB); PG8_STAGE(PG8_SA(0, 0), cA, voffA); PG8_STAGE(PG8_SA(0, 1), cA + hstep, voffA);
        if (wr == 1) PG8_BAR;
        PG8_WAIT_V(2); PG8_BAR;
        PG8_STAGE(PG8_SB(1, 0), cB + kstep, voffB); PG8_STAGE(PG8_SA(1, 0), cA + kstep, voffA); PG8_STAGE(PG8_SB(1, 1), cB + hstep + kstep, voffB);
        PG8_WAIT_V(6); PG8_BAR;
    } else {
        PG8_STAGE(PG8_SB(0, 0), cB, voffB); PG8_STAGE(PG8_SA(0, 0), cA, voffA); PG8_STAGE(PG8_SB(0, 1), cB + hstep, voffB); PG8_STAGE(PG8_SA(0, 1), cA + hstep, voffA);
        if (wr == 1) PG8_BAR;
        PG8_WAIT_V(4); PG8_BAR;
        PG8_STAGE(PG8_SB(1, 0), cB + kstep, voffB); PG8_STAGE(PG8_SA(1, 0), cA + kstep, voffA); PG8_STAGE(PG8_SB(1, 1), cB + hstep + kstep, voffB);
        PG8_WAIT_V(6); PG8_BAR;
    }
    for (;;) {
        const bool has_next = S.next(ui + 1, nxt);
        const char* nA = has_next ? (const char*)g.A + (size_t)nxt.pm * tstep : cA; const char* nB = has_next ? (const char*)g.Bt + (size_t)nxt.pn * tstep : cB;
        for (int t = 0; t < nt; t += 2) {
            const bool last = (t == nt - 2);
            const char* a1 = cA + (size_t)(t + 1) * kstep;
            const char* a2 = last ? nA : cA + (size_t)(t + 2) * kstep; const char* b2 = last ? nB : cB + (size_t)(t + 2) * kstep;
            const char* a3 = a2 + kstep; const char* b3 = b2 + kstep;
            if (last && has_next) S.a_ready(nxt);
            if constexpr (SP2) {
            PG8_LDB(B0, 0, 0); PG8_LDB(B1, 0, 1); PG8_SCHED; PG8_LDA(At, 0, 0); PG8_STAGE(PG8_SA(1, 1), a1 + hstep, voffA);
            PG8_WAIT_V(8); PG8_WAIT_L(0); PG8_BAR; PG8_MMA(0, 0, At, B0); PG8_MMA(0, 1, At, B1); PG8_BAR; PG8_SCHED;
            PG8_LDA(At, 0, 1); PG8_STAGE(PG8_SB(0, 0), b2, voffB); PG8_STAGE(PG8_SB(0, 1), b2 + hstep, voffB); PG8_STAGE(PG8_SA(0, 0), a2, voffA);
            PG8_WAIT_V(8); PG8_WAIT_L(0); PG8_BAR; PG8_MMA(1, 0, At, B0); PG8_MMA(1, 1, At, B1); PG8_BAR; PG8_SCHED;
            PG8_LDB(B0, 1, 0); PG8_LDB(B1, 1, 1); PG8_SCHED; PG8_LDA(At, 1, 0); PG8_STAGE(PG8_SA(0, 1), a2 + hstep, voffA);
            PG8_WAIT_V(8); PG8_WAIT_L(0); PG8_BAR; PG8_MMA(0, 0, At, B0); PG8_MMA(0, 1, At, B1); PG8_BAR; PG8_SCHED;
            PG8_LDA(At, 1, 1); PG8_STAGE(PG8_SB(1, 0), b3, voffB); PG8_STAGE(PG8_SB(1, 1), b3 + hstep, voffB); PG8_STAGE(PG8_SA(1, 0), a3, voffA);
            PG8_WAIT_V(8); PG8_WAIT_L(0); PG8_BAR; PG8_MMA(1, 0, At, B0); PG8_MMA(1, 1, At, B1); PG8_BAR; PG8_SCHED;
            } else {
            PG8_LDB(B0, 0, 0); PG8_SCHED; PG8_LDA(At, 0, 0); PG8_STAGE(PG8_SA(1, 1), a1 + hstep, voffA);
            PG8_WAIT_L(8); PG8_BAR; PG8_WAIT_L(0); PG8_MMA(0, 0, At, B0); PG8_BAR; PG8_SCHED;
            PG8_LDB(B1, 0, 1); PG8_STAGE(PG8_SB(0, 0), b2, voffB);
            PG8_BAR; PG8_WAIT_L(0); PG8_MMA(0, 1, At, B1); PG8_BAR;
            PG8_LDA(At, 0, 1); PG8_STAGE(PG8_SA(0, 0), a2, voffA);
            PG8_BAR; PG8_WAIT_L(0); PG8_MMA(1, 0, At, B0); PG8_BAR; PG8_SCHED;
            PG8_STAGE(PG8_SB(0, 1), b2 + hstep, voffB);
            PG8_WAIT_V(6); PG8_BAR; PG8_MMA(1, 1, At, B1); PG8_BAR;
            PG8_LDB(B0, 1, 0); PG8_SCHED; PG8_LDA(At, 1, 0); PG8_STAGE(PG8_SA(0, 1), a2 + hstep, voffA);
            PG8_WAIT_L(8); PG8_BAR; PG8_WAIT_L(0); PG8_MMA(0, 0, At, B0); PG8_BAR; PG8_SCHED;
            PG8_LDB(B1, 1, 1); PG8_STAGE(PG8_SB(1, 0), b3, voffB);
            PG8_BAR; PG8_WAIT_L(0); PG8_MMA(0, 1, At, B1); PG8_BAR;
            PG8_LDA(At, 1, 1); PG8_STAGE(PG8_SA(1, 0), a3, voffA);
            PG8_BAR; PG8_WAIT_L(0); PG8_MMA(1, 0, At, B0); PG8_BAR; PG8_SCHED;
            PG8_STAGE(PG8_SB(1, 1), b3 + hstep, voffB);
            PG8_WAIT_V(6); PG8_BAR; PG8_MMA(1, 1, At, B1); PG8_BAR;
            }
        }
        if constexpr (ALIGN_EPI) { if (wr == 0) PG8_BAR; }
        if constexpr (!Epi::AFTER_DRAIN) { E(acc, cur, wr, wc, fr, fq); S.done(cur); }
        if (!has_next) break;
#pragma unroll
        for (int a = 0; a < 2; ++a)
#pragma unroll
            for (int b = 0; b < 2; ++b)
#pragma unroll
                for (int m = 0; m < 4; ++m)
#pragma unroll
                    for (int n = 0; n < 2; ++n) acc[a][b][m][n] = (f32x4){0.f, 0.f, 0.f, 0.f};
        cur = nxt; cA = nA; cB = nB; ++ui;
        if constexpr (ALIGN_EPI) { if (wr == 1) PG8_BAR; }
    }
    PG8_WAIT_V(0);
    if constexpr (!ALIGN_EPI) { if (wr == 0) PG8_BAR; }
    PG8_BAR;
#undef PG8_SA
#undef PG8_SB
#undef PG8_STAGE
#undef PG8_LDA
#undef PG8_LDB
#undef PG8_MMA
#undef PG8_WAIT_V
#undef PG8_WAIT_L
#undef PG8_BAR
#undef PG8_SCHED
}
}

DI f32x4 mfma16(bf16x8 a, bf16x8 b, f32x4 c) { return __builtin_amdgcn_mfma_f32_16x16x32_bf16(a, b, c, 0, 0, 0); }
DI bf16x8 frag_row(const LAS unsigned char* base, int pitch, int row, int kelem) { return *(const LAS bf16x8*)(base + row * pitch + kelem * 2); }
DI bf16x8 frag_tr(const LAS unsigned char* base, int pitch, int k0, int col0, int lane) {
    const int g = lane >> 4, q = (lane & 15) >> 2, p = lane & 3;
    const LAS unsigned char* a = base + (k0 + 8 * g + q) * pitch + (col0 + 4 * p) * 2;
    const s16x4 lo = __builtin_bit_cast(s16x4, __builtin_amdgcn_ds_read_tr16_b64_v4i16((LAS s16x4*)a));
    const s16x4 hi = __builtin_bit_cast(s16x4, __builtin_amdgcn_ds_read_tr16_b64_v4i16((LAS s16x4*)(a + 4 * pitch)));
    return __builtin_shufflevector(lo, hi, 0, 1, 2, 3, 4, 5, 6, 7);
}
#define WG_BAR() __syncthreads()

constexpr int RP = 272, PP = 144;
constexpr int R_Q = 0, R_K = 64 * RP, R_V = 2 * 64 * RP, R_VD = 3 * 64 * RP, R_P = 4 * 64 * RP, R_S = R_P + 64 * PP, R_ST = R_S + 128 * RP, R_END = R_ST + 1024;
static_assert(R_END <= 131072, "retention LDS");
__device__ __forceinline__ void retention_unit(LAS unsigned char* lds, int unit, const bf16_t* __restrict__ Z, bf16_t* __restrict__ Y, const float* __restrict__ ret_g) {
    const int tid = threadIdx.x, lane = tid & 63, w = __builtin_amdgcn_readfirstlane(tid >> 6), l15 = lane & 15, q4 = lane >> 4;
    const int b = unit >> 2, h = unit & 3;
    const size_t row0 = (size_t)b * SEQ;
    float lg; { const float x = __builtin_amdgcn_exp2f(-5.0f - (float)h); float s = 1.0f / 8.0f; for (int k = 7; k >= 1; --k) s = s * x + 1.0f / (float)k; lg = -(s * x) * 1.4426950409f; }
    const float cdec = __builtin_amdgcn_exp2f(64.0f * lg);
    f32x4 st[8];
#pragma unroll
    for (int t = 0; t < 8; ++t) st[t] = (f32x4){0.f, 0.f, 0.f, 0.f};
    for (int i = tid; i < 128 * RP / 16; i += 512) *(LAS u32x4*)(lds + R_S + i * 16) = (u32x4){0u, 0u, 0u, 0u};
    const int ldr = tid >> 4, ldc16 = tid & 15;
    u32x4 rq[2], rk[2], rv[2];
    {
#pragma unroll
        for (int rep = 0; rep < 2; ++rep) { const bf16_t* zp = Z + (row0 + ldr + 32 * rep) * NIN + h * 128 + ldc16 * 8;
            rq[rep] = *(const u32x4*)zp; rk[rep] = *(const u32x4*)(zp + 512); rv[rep] = *(const u32x4*)(zp + 1024); }
    }
    f32x4 gn[4];
    { const int eh = w >> 2;
#pragma unroll
      for (int t = 0; t < 4; ++t) gn[t] = *(const f32x4*)(ret_g + h * 128 + 16 * (4 * eh + t) + 4 * q4); }
    for (int n = 0; n < SEQ / 64; ++n) {
#pragma unroll
        for (int rep = 0; rep < 2; ++rep) { const int r = ldr + 32 * rep; const int o = r * RP + ldc16 * 16;
            *(LAS u32x4*)(lds + R_Q + o) = rq[rep]; *(LAS u32x4*)(lds + R_K + o) = rk[rep]; *(LAS u32x4*)(lds + R_V + o) = rv[rep];
            const float kd = __builtin_amdgcn_exp2f(lg * (float)(63 - r)); const u32x4 v = rv[rep]; u32x4 d;
            d.x = cvt_pk_bf16(bf_lo(v.x) * kd, bf_hi(v.x) * kd); d.y = cvt_pk_bf16(bf_lo(v.y) * kd, bf_hi(v.y) * kd); d.z = cvt_pk_bf16(bf_lo(v.z) * kd, bf_hi(v.z) * kd); d.w = cvt_pk_bf16(bf_lo(v.w) * kd, bf_hi(v.w) * kd);
            *(LAS u32x4*)(lds + R_VD + o) = d; }
        WG_BAR();
        if (n + 1 < SEQ / 64) {
#pragma unroll
            for (int rep = 0; rep < 2; ++rep) { const bf16_t* zp = Z + (row0 + (size_t)(n + 1) * 64 + ldr + 32 * rep) * NIN + h * 128 + ldc16 * 8;
                rq[rep] = *(const u32x4*)zp; rk[rep] = *(const u32x4*)(zp + 512); rv[rep] = *(const u32x4*)(zp + 1024); }
        }
        const int ti = w & 3, eh = w >> 2;
        const size_t orow = row0 + (size_t)n * 64 + 16 * ti + l15;
        u32x2 gt[4];
#pragma unroll
        for (int t = 0; t < 4; ++t) gt[t] = *(const u32x2*)(Z + orow * NIN + 1536 + h * 128 + 16 * (4 * eh + t) + 4 * q4);
        {
            const int tj = w >> 1, ti0 = 2 * (w & 1);
            f32x4 s0 = (f32x4){0.f, 0.f, 0.f, 0.f}, s1 = s0;
#pragma unroll
            for (int ks = 0; ks < 4; ++ks) { const bf16x8 a = frag_row(lds + R_K, RP, 16 * tj + l15, 32 * ks + 8 * q4);
                const bf16x8 b0 = frag_row(lds + R_Q, RP, 16 * ti0 + l15, 32 * ks + 8 * q4), b1 = frag_row(lds + R_Q, RP, 16 * ti0 + 16 + l15, 32 * ks + 8 * q4);
                s0 = mfma16(a, b0, s0); s1 = mfma16(a, b1, s1); }
#pragma unroll
            for (int x = 0; x < 2; ++x) { const f32x4 s = x ? s1 : s0; const int i = 16 * (ti0 + x) + l15, j0 = 16 * tj + 4 * q4; float pv[4];
#pragma unroll
                for (int jj = 0; jj < 4; ++jj) { const int dj = i - (j0 + jj); const float ex = (float)((dj < 0 ? -dj : dj) - (i + 1)); pv[jj] = s[jj] * __builtin_amdgcn_exp2f(lg * ex); }
                u32x2 o; o.x = cvt_pk_bf16(pv[0], pv[1]); o.y = cvt_pk_bf16(pv[2], pv[3]);
                *(LAS u32x2*)(lds + R_P + i * PP + j0 * 2) = o; }
        }
        WG_BAR();
        f32x4 o[4];
        {
            bf16x8 bP[2], bQ[4];
#pragma unroll
            for (int ks = 0; ks < 2; ++ks) bP[ks] = frag_row(lds + R_P, PP, 16 * ti + l15, 32 * ks + 8 * q4);
#pragma unroll
            for (int ks = 0; ks < 4; ++ks) bQ[ks] = frag_row(lds + R_Q, RP, 16 * ti + l15, 32 * ks + 8 * q4);
#pragma unroll
            for (int t = 0; t < 4; ++t) { const int e0 = 16 * (4 * eh + t); f32x4 a_ = (f32x4){0.f, 0.f, 0.f, 0.f};
#pragma unroll
                for (int ks = 0; ks < 2; ++ks) a_ = mfma16(frag_tr(lds + R_V, RP, 32 * ks, e0, lane), bP[ks], a_);
#pragma unroll
                for (int ks = 0; ks < 4; ++ks) a_ = mfma16(frag_tr(lds + R_S, RP, 32 * ks, e0, lane), bQ[ks], a_);
                o[t] = a_; }
        }
        {
            bf16x8 bK[2];
#pragma unroll
            for (int ks = 0; ks < 2; ++ks) bK[ks] = frag_tr(lds + R_K, RP, 32 * ks, 16 * w, lane);
#pragma unroll
            for (int te = 0; te < 8; ++te) { f32x4 a_ = st[te] * cdec;
#pragma unroll
                for (int ks = 0; ks < 2; ++ks) a_ = mfma16(frag_tr(lds + R_VD, RP, 32 * ks, 16 * te, lane), bK[ks], a_);
                st[te] = a_; }
        }
        {
            const float qd = __builtin_amdgcn_exp2f(lg * (float)(16 * ti + l15 + 1)); float s = 0.f, s2 = 0.f;
#pragma unroll
            for (int t = 0; t < 4; ++t) { o[t] = o[t] * qd;
#pragma unroll
                for (int jj = 0; jj < 4; ++jj) { s += o[t][jj]; s2 += o[t][jj] * o[t][jj]; } }
            s += __shfl_xor(s, 16); s += __shfl_xor(s, 32); s2 += __shfl_xor(s2, 16); s2 += __shfl_xor(s2, 32);
            if (q4 == 0) *(LAS f32x2*)(lds + R_ST + (eh * 64 + 16 * ti + l15) * 8) = (f32x2){s, s2};
        }
        WG_BAR();
#pragma unroll
        for (int te = 0; te < 8; ++te) { u32x2 pk; pk.x = cvt_pk_bf16(st[te][0], st[te][1]); pk.y = cvt_pk_bf16(st[te][2], st[te][3]);
            *(LAS u32x2*)(lds + R_S + (16 * w + l15) * RP + (16 * te + 4 * q4) * 2) = pk; }
        {
            const f32x2 p0 = *(const LAS f32x2*)(lds + R_ST + (16 * ti + l15) * 8), p1 = *(const LAS f32x2*)(lds + R_ST + (64 + 16 * ti + l15) * 8);
            const float mean = (p0.x + p1.x) * (1.0f / 128.0f); const float var = fmaxf((p0.y + p1.y) * (1.0f / 128.0f) - mean * mean, 0.f);
            const float rstd = __builtin_amdgcn_rsqf(var + EPS);
#pragma unroll
            for (int t = 0; t < 4; ++t) { f32x4 y = (o[t] - mean) * rstd * gn[t];
                y[0] *= bf_lo(gt[t].x); y[1] *= bf_hi(gt[t].x); y[2] *= bf_lo(gt[t].y); y[3] *= bf_hi(gt[t].y);
                u32x2 pk; pk.x = cvt_pk_bf16(y[0], y[1]); pk.y = cvt_pk_bf16(y[2], y[3]);
                *(u32x2*)(Y + orow * DM + h * 128 + 16 * (4 * eh + t) + 4 * q4) = pk; }
        }
        WG_BAR();
    }
}

constexpr int SGP = 1040;
static_assert(128 * SGP <= LDS_BYTES, "sg LDS");
__device__ __forceinline__ void sg_unit(LAS unsigned char* lds, int unit, const bf16_t* __restrict__ Z, bf16_t* __restrict__ Y, const bf16_t* __restrict__ Wsb, const float* __restrict__ b_s, const float* __restrict__ sg_g) {
    const int tid = threadIdx.x, lane = tid & 63, w = __builtin_amdgcn_readfirstlane(tid >> 6), l15 = lane & 15, q4 = lane >> 4;
    const size_t row0 = (size_t)unit * 128;
    {
        const f32x4 g0 = *(const f32x4*)(sg_g + 8 * lane), g1 = *(const f32x4*)(sg_g + 8 * lane + 4);
#pragma unroll 4
        for (int jj = 0; jj < 16; ++jj) { const int j = 16 * w + jj;
            const u32x4 raw = *(const u32x4*)(Z + (row0 + j) * NIN + 2560 + 8 * lane);
            float v[8] = {bf_lo(raw.x), bf_hi(raw.x), bf_lo(raw.y), bf_hi(raw.y), bf_lo(raw.z), bf_hi(raw.z), bf_lo(raw.w), bf_hi(raw.w)};
            float s = 0.f, s2 = 0.f;
#pragma unroll
            for (int e = 0; e < 8; ++e) { s += v[e]; s2 += v[e] * v[e]; }
            s = wave_sum(s); s2 = wave_sum(s2);
            const float mean = s * (1.0f / 512.0f), var = fmaxf(s2 * (1.0f / 512.0f) - mean * mean, 0.f), rstd = __builtin_amdgcn_rsqf(var + EPS);
            u32x4 o; o.x = cvt_pk_bf16((v[0] - mean) * rstd * g0[0], (v[1] - mean) * rstd * g0[1]); o.y = cvt_pk_bf16((v[2] - mean) * rstd * g0[2], (v[3] - mean) * rstd * g0[3]);
            o.z = cvt_pk_bf16((v[4] - mean) * rstd * g1[0], (v[5] - mean) * rstd * g1[1]); o.w = cvt_pk_bf16((v[6] - mean) * rstd * g1[2], (v[7] - mean) * rstd * g1[3]);
            *(LAS u32x4*)(lds + j * SGP + 16 * lane) = o; }
    }
    WG_BAR();
    const int i = 16 * w + l15;
#pragma unroll 1
    for (int g = 0; g < 4; ++g) {
        bf16x8 wf[4];
#pragma unroll
        for (int ks = 0; ks < 4; ++ks) wf[ks] = *(const bf16x8*)(Wsb + ((size_t)(g * 128 + i) * 128 + 32 * ks + 8 * q4));
        const float bias = b_s[g * 128 + i];
#pragma unroll 2
        for (int tc = 0; tc < 8; ++tc) { const int c0 = 128 * g + 16 * tc;
            const u32x2 uu = *(const u32x2*)(Z + (row0 + i) * NIN + 2048 + c0 + 4 * q4);
            f32x4 a_ = (f32x4){0.f, 0.f, 0.f, 0.f};
#pragma unroll
            for (int ks = 0; ks < 4; ++ks) a_ = mfma16(frag_tr(lds, SGP, 32 * ks, c0, lane), wf[ks], a_);
            u32x2 pk; pk.x = cvt_pk_bf16(bf_lo(uu.x) * (a_[0] + bias), bf_hi(uu.x) * (a_[1] + bias)); pk.y = cvt_pk_bf16(bf_lo(uu.y) * (a_[2] + bias), bf_hi(uu.y) * (a_[3] + bias));
            *(u32x2*)(Y + (row0 + i) * DM + 512 + c0 + 4 * q4) = pk; }
    }
    WG_BAR();
}

__device__ __forceinline__ void transpose_item(const float* __restrict__ W, int K, int N, bf16_t* __restrict__ WT, int perm_lim, LAS float* scr, int item, int lane) {
    const int nblk = N / 32, kb = item / nblk, nb = item % nblk, k0 = 64 * kb, n0 = 32 * nb;
#pragma unroll 8
    for (int i = 0; i < 32; ++i) { const int kk = 2 * i + (lane >> 5); scr[kk * 33 + (lane & 31)] = W[(size_t)(k0 + kk) * N + n0 + (lane & 31)]; }
    asm volatile("s_waitcnt lgkmcnt(0)" ::: "memory");
    const int c = lane & 7;
#pragma unroll
    for (int j = 0; j < 4; ++j) { const int n = (lane >> 3) + 8 * j; const LAS float* s = scr + (8 * c) * 33 + n;
        u32x4 o; o.x = cvt_pk_bf16(s[0 * 33], s[1 * 33]); o.y = cvt_pk_bf16(s[2 * 33], s[3 * 33]); o.z = cvt_pk_bf16(s[4 * 33], s[5 * 33]); o.w = cvt_pk_bf16(s[6 * 33], s[7 * 33]);
        int nl = n0 + n; if (nl < perm_lim) { const int jh = nl & 127; nl = (nl & ~127) + 2 * (jh & 63) + (jh >> 6); }
        *(u32x4*)(WT + (size_t)nl * K + k0 + 8 * c) = o; }
    asm volatile("s_waitcnt lgkmcnt(0)" ::: "memory");
}

struct Args { const float* in[16]; float* out; unsigned char* ws; int ph_lo, ph_hi; };

__global__ void __launch_bounds__(512, 2) fwd_mega(Args a) {
    extern __shared__ __attribute__((aligned(16))) unsigned char lds_raw[];
    LAS unsigned char* lds = (LAS unsigned char*)lds_raw;
    const int G = gridDim.x, bid = blockIdx.x;
    const int lo = a.ph_lo, hi = a.ph_hi;
#define IN_PH(k) (lo <= (k) && (k) < hi)
#define SEAM(k) do { if (IN_PH(k) && IN_PH((k) + 1)) cg::this_grid().sync(); } while (0)
#define FRESH_IDS() int tid = threadIdx.x; asm volatile("" : "+v"(tid)); const int lane = tid & 63, wave = __builtin_amdgcn_readfirstlane(tid >> 6); (void)lane; (void)wave
    const float *x = a.in[0], *p = a.in[1], *g_mix = a.in[2], *w_in = a.in[3], *ret_g = a.in[4], *sg_g = a.in[5], *w_s = a.in[6], *b_s = a.in[7], *w_out = a.in[8], *g_ffn = a.in[9],
                *w_ff1 = a.in[10], *w_ff2 = a.in[11], *g_ple = a.in[12], *w_gate = a.in[13], *w_ple = a.in[14], *g_final = a.in[15];
    unsigned char* ws = a.ws; float* out = a.out;
    bf16_t *WinT = (bf16_t*)(ws + WS_WIN), *WoutT = (bf16_t*)(ws + WS_WOUT), *Wff1T = (bf16_t*)(ws + WS_WFF1), *Wff2T = (bf16_t*)(ws + WS_WFF2), *WgateT = (bf16_t*)(ws + WS_WGATE), *WpleT = (bf16_t*)(ws + WS_WPLE);
    bf16_t *Wsb = (bf16_t*)(ws + WS_WS); float* rope = (float*)(ws + WS_ROPE);
    float *SS1 = (float*)(ws + WS_SS1), *SS2 = (float*)(ws + WS_SS2), *SS3 = (float*)(ws + WS_SS3);
    bf16_t *H0 = (bf16_t*)(ws + WS_H0), *Yb = H0, *A2 = H0, *A1 = (bf16_t*)(ws + WS_A1), *Zb = (bf16_t*)(ws + WS_Z), *HF = Zb, *Pb = (bf16_t*)(ws + WS_PB), *PW = (bf16_t*)(ws + WS_PW);

    if (IN_PH(0)) {
        FRESH_IDS();
        LAS float* scr = (LAS float*)(lds + wave * 16384);
        const int gw = bid * 8 + wave, NGW = G * 8;
        constexpr int I_IN = (DM / 64) * (NIN / 32), I_OUT = (DM / 64) * (DM / 32), I_F1 = (DM / 64) * (DFF / 32), I_F2 = (DFF / 64) * (DM / 32), I_G = I_OUT, I_P = (PLE / 64) * (DM / 32);
        constexpr int NITEMS = I_IN + I_OUT + I_F1 + I_F2 + I_G + I_P;
        for (int it = gw; it < NITEMS; it += NGW) {
            int r = it;
            if (r < I_IN) { transpose_item(w_in, DM, NIN, WinT, 1024, scr, r, lane); continue; } r -= I_IN;
            if (r < I_OUT) { transpose_item(w_out, DM, DM, WoutT, 0, scr, r, lane); continue; } r -= I_OUT;
            if (r < I_F1) { transpose_item(w_ff1, DM, DFF, Wff1T, 0, scr, r, lane); continue; } r -= I_F1;
            if (r < I_F2) { transpose_item(w_ff2, DFF, DM, Wff2T, 0, scr, r, lane); continue; } r -= I_F2;
            if (r < I_G) { transpose_item(w_gate, DM, DM, WgateT, 0, scr, r, lane); continue; } r -= I_G;
            transpose_item(w_ple, PLE, DM, WpleT, 0, scr, r, lane);
        }
        const int gt = bid * 512 + tid, NGT = G * 512;
        for (int c = gt; c < 4 * 128 * 128 / 8; c += NGT) { const int e = c * 8, i = (e >> 7) & 127, j = e & 127; const bool ok = (j >> 6) <= (i >> 6);
            const f32x4 a0 = *(const f32x4*)(w_s + e), a1 = *(const f32x4*)(w_s + e + 4); u32x4 o = (u32x4){0u, 0u, 0u, 0u};
            if (ok) { o.x = cvt_pk_bf16(a0[0], a0[1]); o.y = cvt_pk_bf16(a0[2], a0[3]); o.z = cvt_pk_bf16(a1[0], a1[1]); o.w = cvt_pk_bf16(a1[2], a1[3]); }
            *(u32x4*)(Wsb + e) = o; }
        for (int e = gt; e < SEQ * 64; e += NGT) { const int pos = e >> 6, t = e & 63;
            const float freq = (float)exp2(-(double)(2 * t) * (13.287712379549449 / 128.0)); const float ang = (float)pos * freq;
            const double rev = (double)ang * 0.15915494309189535; const float fr = (float)(rev - rint(rev));
            rope[e] = __builtin_amdgcn_cosf(fr); rope[SEQ * 64 + e] = __builtin_amdgcn_sinf(fr); }
        for (size_t c = gt; c < (size_t)MTOK * PLE / 8; c += NGT) { const f32x4 a0 = *(const f32x4*)(p + c * 8), a1 = *(const f32x4*)(p + c * 8 + 4);
            u32x4 o; o.x = cvt_pk_bf16(a0[0], a0[1]); o.y = cvt_pk_bf16(a0[2], a0[3]); o.z = cvt_pk_bf16(a1[0], a1[1]); o.w = cvt_pk_bf16(a1[2], a1[3]); *(u32x4*)(Pb + c * 8) = o; }
        { f32x4 gv[4];
#pragma unroll
          for (int j = 0; j < 4; ++j) gv[j] = *(const f32x4*)(g_mix + 4 * lane + 256 * j);
          for (int m = gw; m < MTOK; m += NGW) { const f32x4* xr = (const f32x4*)(x + (size_t)m * DM) + lane; f32x4 v[4]; float s = 0.f;
#pragma unroll
            for (int j = 0; j < 4; ++j) { v[j] = xr[64 * j]; s += (v[j][0] * v[j][0] + v[j][1] * v[j][1]) + (v[j][2] * v[j][2] + v[j][3] * v[j][3]); }
            const float rstd = __builtin_amdgcn_rsqf(wave_sum(s) * (1.0f / DM) + EPS);
            u32x2* o8 = (u32x2*)(H0 + (size_t)m * DM) + lane;
#pragma unroll
            for (int j = 0; j < 4; ++j) { const f32x4 y = v[j] * rstd * gv[j]; u32x2 pk; pk.x = cvt_pk_bf16(y[0], y[1]); pk.y = cvt_pk_bf16(y[2], y[3]); o8[64 * j] = pk; } } }
        __syncthreads();
    }
    SEAM(0);
    if (IN_PH(1)) {
        { pg8::Gemm g{H0, WinT, MTOK, NIN, DM}; pg8::StaticOrder S; S.init(MTOK, NIN, G, bid);
          pg8::Epi<pg8::EPI_IN> E{Zb, NIN, nullptr, nullptr, nullptr, nullptr, nullptr, nullptr, rope};
          pg8::gemm_phase<pg8::Epi<pg8::EPI_IN>, pg8::StaticOrder, true, true>(lds, g, S, E); }
        { pg8::Gemm g{Pb, WpleT, MTOK, DM, PLE}; pg8::StaticOrder S; S.init(MTOK, DM, G, bid);
          pg8::Epi<pg8::EPI_PLAIN> E{PW, DM, nullptr, nullptr, nullptr, nullptr, nullptr, nullptr, nullptr};
          pg8::gemm_phase<pg8::Epi<pg8::EPI_PLAIN>, pg8::StaticOrder, true, true>(lds, g, S, E); }
    }
    SEAM(1);
    if (IN_PH(2)) {
        const int nret = G / 2, nsg = G - nret;
        if (bid < nret) { for (int u = bid; u < 128; u += nret) retention_unit(lds, u, Zb, Yb, ret_g); }
        else { for (int u = bid - nret; u < 512; u += nsg) sg_unit(lds, u, Zb, Yb, Wsb, b_s, sg_g); }
    }
    SEAM(2);
    if (IN_PH(3)) {
        pg8::Gemm g{Yb, WoutT, MTOK, DM, DM}; pg8::StaticOrder S; S.init(MTOK, DM, G, bid);
        pg8::Epi<pg8::EPI_RES> E{A1, DM, x, out, g_ffn, nullptr, SS1, nullptr, nullptr};
        pg8::gemm_phase<pg8::Epi<pg8::EPI_RES>, pg8::StaticOrder, true, true>(lds, g, S, E);
    }
    SEAM(3);
    if (IN_PH(4)) {
        pg8::Gemm g{A1, Wff1T, MTOK, DFF, DM}; pg8::StaticOrder S; S.init(MTOK, DFF, G, bid);
        pg8::Epi<pg8::EPI_FF1> E{HF, DFF, nullptr, nullptr, nullptr, SS1, nullptr, nullptr, nullptr};
        pg8::gemm_phase<pg8::Epi<pg8::EPI_FF1>, pg8::StaticOrder, true, true>(lds, g, S, E);
    }
    SEAM(4);
    if (IN_PH(5)) {
        pg8::Gemm g{HF, Wff2T, MTOK, DM, DFF}; pg8::StaticOrder S; S.init(MTOK, DM, G, bid);
        pg8::Epi<pg8::EPI_RES> E{A2, DM, out, out, g_ple, nullptr, SS2, nullptr, nullptr};
        pg8::gemm_phase<pg8::Epi<pg8::EPI_RES>, pg8::StaticOrder, true, true>(lds, g, S, E);
    }
    SEAM(5);
    if (IN_PH(6)) {
        pg8::Gemm g{A2, WgateT, MTOK, DM, DM}; pg8::StaticOrder S; S.init(MTOK, DM, G, bid);
        pg8::Epi<pg8::EPI_GATE> E{nullptr, DM, out, out, nullptr, SS2, SS3, PW, nullptr};
        pg8::gemm_phase<pg8::Epi<pg8::EPI_GATE>, pg8::StaticOrder, true, true>(lds, g, S, E);
    }
    SEAM(6);
    if (IN_PH(7)) {
        FRESH_IDS();
        const int gw = bid * 8 + wave, NGW = G * 8;
        f32x4 gv[4];
#pragma unroll
        for (int j = 0; j < 4; ++j) gv[j] = *(const f32x4*)(g_final + 4 * lane + 256 * j);
        for (int m = gw; m < MTOK; m += NGW) { f32x4* xr = (f32x4*)(out + (size_t)m * DM) + lane; f32x4 v[4];
#pragma unroll
            for (int j = 0; j < 4; ++j) v[j] = xr[64 * j];
            float s = (lane < 16) ? SS3[(size_t)m * 16 + lane] : 0.f; s = wave_sum(s);
            const float rstd = __builtin_amdgcn_rsqf(s * (1.0f / DM) + EPS);
#pragma unroll
            for (int j = 0; j < 4; ++j) xr[64 * j] = v[j] * rstd * gv[j]; }
    }
#undef IN_PH
#undef SEAM
}

extern "C" void kernel_launch(void* const* d_in, const int* in_sizes, int n_in, void* d_out, int out_size, void* d_ws, size_t ws_size, hipStream_t stream) {
    static int grid = 0;
    if (grid == 0) {
        if (n_in != 16 || in_sizes[0] != MTOK * DM || out_size != MTOK * DM || ws_size < WS_END) { fprintf(stderr, "kernel_launch: unexpected shapes (n_in %d, in0 %d, out %d, ws %zu)\n", n_in, n_in > 0 ? in_sizes[0] : -1, out_size, ws_size); grid = -1; return; }
        int dev = 0, cus = 0, per_cu = 0;
        hipGetDevice(&dev); hipDeviceGetAttribute(&cus, hipDeviceAttributeMultiprocessorCount, dev);
        hipFuncSetAttribute((const void*)fwd_mega, hipFuncAttributeMaxDynamicSharedMemorySize, LDS_BYTES);
        hipOccupancyMaxActiveBlocksPerMultiprocessor(&per_cu, (const void*)fwd_mega, 512, LDS_BYTES);
        (void)hipGetLastError();
        if (per_cu < 1) { fprintf(stderr, "kernel_launch: occupancy query says %d blocks per CU\n", per_cu); per_cu = 1; }
        grid = cus * per_cu; if (grid > 256) grid = 256;
    }
    if (grid < 0) return;
    Args a{};
    for (int i = 0; i < 16; ++i) a.in[i] = (const float*)d_in[i];
    a.out = (float*)d_out; a.ws = (unsigned char*)d_ws;
#if MK_N_LAUNCHES == 1
    a.ph_lo = 0; a.ph_hi = 8;
    void* args[] = {&a};
    hipError_t e = hipLaunchCooperativeKernel((const void*)fwd_mega, dim3(grid), dim3(512), args, LDS_BYTES, stream);
    if (e != hipSuccess) fprintf(stderr, "cooperative launch failed: %s (grid %d)\n", hipGetErrorString(e), grid);
#else
    for (int ph = 0; ph < 8; ++ph) { a.ph_lo = ph; a.ph_hi = ph + 1; hipLaunchKernelGGL(fwd_mega, dim3(grid), dim3(512), LDS_BYTES, stream, a); }
#endif
}
```
